# Optimizing an MI355X kernel written in HIP

```python
import math
import jax, jax.numpy as jnp
from jax import lax
import numpy as np

D_MODEL = 1024
BATCH = 16
SEQ = 256
DEPTH = 4
DEC_BATCH = 8
DEC_SEQ = 1024
PAST_LEN = 256

GRID_W = 64
N_EVEN = (DEPTH + 1) // 2
N_ODD = DEPTH // 2
D_A = D_MODEL
HEADDIM = 64
N_HEADS_A = D_A // HEADDIM
N_GROUPS_A = 4
D_STATE = 128
CONV_A = 3
CHUNK = 128
XBC_A = D_A + 2 * N_GROUPS_A * D_STATE
D_B = D_MODEL
CONV_B = 3
D_C = 2 * D_MODEL
POOL_WINDOWS = (2, 4, 8, 16)
N_POOL = len(POOL_WINDOWS)
D_POOL_GRP = D_C // N_POOL
SPLIT_EVEN = (D_A, D_A + XBC_A, D_A + XBC_A + N_HEADS_A, D_A + XBC_A + 2 * N_HEADS_A,
              D_A + XBC_A + 2 * N_HEADS_A + D_B, D_A + XBC_A + 2 * N_HEADS_A + 2 * D_B,
              D_A + XBC_A + 2 * N_HEADS_A + 3 * D_B)
IN_EVEN = D_A + XBC_A + 2 * N_HEADS_A + 4 * D_B
IN_ODD = 2 * D_C
ALPHA = (2 * DEPTH) ** 0.25
BETA = (8 * DEPTH) ** -0.25
LN_EPS = 1e-5
RMS_EPS = 1e-5
POS_BASE = 10000.0

kernel_name = 'hybrid_ssd_shortconv_pool_flow_step'

f32 = jnp.float32


def layer_norm(x, g, b):
    xf = x.astype(f32)
    mu = jnp.mean(xf, axis=-1, keepdims=True)
    var = jnp.mean(jnp.square(xf - mu), axis=-1, keepdims=True)
    return ((xf - mu) * lax.rsqrt(var + LN_EPS) * g.astype(f32) + b.astype(f32)).astype(x.dtype)


def rms_norm(x, g):
    xf = x.astype(f32)
    return xf * lax.rsqrt(jnp.mean(jnp.square(xf), axis=-1, keepdims=True) + RMS_EPS) * g.astype(f32)


def dwconv_centred(x, w):
    K = w.shape[0]
    p = K // 2
    L = x.shape[1]
    xp = jnp.pad(x, ((0, 0), (p, p), (0, 0)))
    return sum(xp[:, k:k + L] * w[k] for k in range(K))


def pos_embed_2d(L, dim):
    rows = L // GRID_W
    t = jnp.arange(rows * GRID_W)
    r = (t // GRID_W).astype(f32)
    col = (t % GRID_W).astype(f32)
    nf = dim // 4
    omega = 1.0 / (POS_BASE ** (jnp.arange(nf, dtype=f32) / nf))

    def emb(pos):
        a = pos[:, None] * omega[None, :]
        return jnp.concatenate([jnp.sin(a), jnp.cos(a)], axis=-1)

    return jnp.concatenate([emb(r), emb(col)], axis=-1)


def ssd_chunked(x, dt, A, bm, cm, h0):
    b, L, H, P = x.shape
    G, N = bm.shape[2], bm.shape[3]
    R = H // G
    Q = CHUNK
    nc = L // Q
    x = x.reshape(b, nc, Q, G, R, P)
    dt = dt.reshape(b, nc, Q, G, R)
    bm = bm.reshape(b, nc, Q, G, N)
    cm = cm.reshape(b, nc, Q, G, N)
    a_cum = jnp.cumsum(dt * A.reshape(G, R), axis=2)
    lower = jnp.tril(jnp.ones((Q, Q), dtype=bool))[None, None, :, :, None, None]
    seg = a_cum[:, :, :, None] - a_cum[:, :, None, :]
    decay = jnp.exp(jnp.where(lower, seg, -jnp.inf))
    xdt = x * dt[..., None]
    cb = jnp.einsum('bcign,bcjgn->bcijg', cm, bm)
    y_diag = jnp.einsum('bcijgr,bcjgrp->bcigrp', cb[..., None] * decay, xdt)
    decay_end = jnp.exp(a_cum[:, :, -1:] - a_cum)
    chunk_states = jnp.einsum('bcjgn,bcjgrp->bcgrpn', bm, decay_end[..., None] * xdt)
    chunk_decay = jnp.exp(a_cum[:, :, -1])

    def step(h, inp):
        s, d = inp
        return h * d[..., None, None] + s, h

    h_last, h_starts = lax.scan(step, h0.astype(f32).reshape(b, G, R, P, N),
                                (jnp.moveaxis(chunk_states, 1, 0), jnp.moveaxis(chunk_decay, 1, 0)))
    h_starts = jnp.moveaxis(h_starts, 0, 1)
    y_off = jnp.einsum('bcign,bcgrpn->bcigrp', cm, h_starts) * jnp.exp(a_cum)[..., None]
    return (y_diag + y_off).reshape(b, L, H, P), h_last.reshape(b, H, P, N)


def ssd_mixer(z, xbc, dtf, dtb, conv_w, conv_b, a_log, dt_bias, d_skip, norm_g, h0_f, h0_b):
    Bsz, L, _ = z.shape
    xbc = jax.nn.silu(dwconv_centred(xbc, conv_w) + conv_b)
    xs, bm, cm = jnp.split(xbc, [D_A, D_A + N_GROUPS_A * D_STATE], axis=-1)
    xs = xs.reshape(Bsz, L, N_HEADS_A, HEADDIM).astype(f32)
    bm = bm.reshape(Bsz, L, N_GROUPS_A, D_STATE).astype(f32)
    cm = cm.reshape(Bsz, L, N_GROUPS_A, D_STATE).astype(f32)
    A = -jnp.exp(a_log.astype(f32))
    dt = jax.nn.softplus(jnp.stack([dtf, dtb], 0).astype(f32) + dt_bias.astype(f32)[:, None, None, :])
    y_f, h_f = ssd_chunked(xs, dt[0], A[0], bm, cm, h0_f)
    y_b, h_b = ssd_chunked(xs[:, ::-1], dt[1][:, ::-1], A[1], bm[:, ::-1], cm[:, ::-1], h0_b)
    y = y_f + y_b[:, ::-1] + d_skip.astype(f32)[:, None] * xs
    y = y.reshape(Bsz, L, D_A) * jax.nn.silu(z.astype(f32))
    return rms_norm(y, norm_g).astype(z.dtype), h_f, h_b


def multiscale_pool(v):
    L = v.shape[1]
    vf = v.astype(f32)
    cs = jnp.pad(jnp.cumsum(vf, axis=1), ((0, 0), (1, 0), (0, 0)))
    t = jnp.arange(L)
    outs = []
    for k, w in enumerate(POOL_WINDOWS):
        lo = jnp.clip(t - w // 2, 0, L)
        hi = jnp.clip(t + w - w // 2, 0, L)
        sl = slice(k * D_POOL_GRP, (k + 1) * D_POOL_GRP)
        seg = cs[:, :, sl]
        cnt = (hi - lo).astype(f32)[None, :, None]
        outs.append((seg[:, hi] - seg[:, lo]) / cnt - vf[:, :, sl])
    return jnp.concatenate(outs, axis=-1).astype(v.dtype)


def trunk(x, cvec, h0, w_mod, b_mod, ln_g, ln_b, w_in_even, conv_a_w, conv_a_b, a_log, dt_bias,
          d_skip, norm_a_g, conv_b_w, w_out_even, w_in_odd, w_pool, pool_scale, w_out_odd):
    Bsz, L, _ = x.shape
    states = []
    for i in range(DEPTH):
        j = i // 2
        mod = jnp.dot(jax.nn.silu(cvec), w_mod[i]) + b_mod[i]
        shift, scale, gate = jnp.split(mod[:, None, :], 3, axis=-1)
        u = x * (1 + scale) + shift
        if i % 2 == 0:
            proj = u @ w_in_even[j]
            z, xbc, dtf, dtb, g, bg, cg, h_in = jnp.split(proj, SPLIT_EVEN, axis=-1)
            y_a, h_f, h_b = ssd_mixer(z, xbc, dtf, dtb, conv_a_w[j], conv_a_b[j], a_log[j], dt_bias[j],
                                      d_skip[j], norm_a_g[j], h0[:, j, 0], h0[:, j, 1])
            y_b = bg * dwconv_centred(cg * h_in, conv_b_w[j]) * jax.nn.silu(g)
            y = jnp.concatenate([y_a, y_b], axis=-1) @ w_out_even[j]
            states.append(jnp.stack([h_f, h_b], axis=1).astype(h0.dtype))
        else:
            v, g = jnp.split(u @ w_in_odd[j], 2, axis=-1)
            p = multiscale_pool(v).reshape(Bsz, L, N_POOL, D_POOL_GRP)
            p = jnp.einsum('blkc,kcd->blkd', p, w_pool[j]).reshape(Bsz, L, D_C) * pool_scale[j]
            y = (p * jax.nn.silu(g)) @ w_out_odd[j]
        x = layer_norm(ALPHA * x + (1 + gate) * y, ln_g[i], ln_b[i])
    return x, jnp.stack(states, axis=1)


def setup_inputs(seed: int = 0) -> dict:
    key = jax.random.key(seed)
    ks = jax.random.split(key, 24)
    D = D_MODEL
    nrm = jax.random.normal
    dt0 = jnp.exp(jax.random.uniform(ks[11], (N_EVEN, 2, N_HEADS_A), minval=math.log(1e-3), maxval=math.log(1e-1)))
    return {
        'x_prompt': nrm(ks[0], (BATCH, SEQ, D), f32),
        'x_sample': nrm(ks[1], (DEC_BATCH, DEC_SEQ, D), f32),
        'state_ssd': 0.1 * nrm(ks[2], (DEC_BATCH, N_EVEN, 2, N_HEADS_A, HEADDIM, D_STATE), f32),
        'c': nrm(ks[3], (DEC_BATCH, D), f32),
        'c_ctx': nrm(ks[4], (D,), f32),
        'w_mod': 0.5 * D ** -0.5 * nrm(ks[5], (DEPTH, D, 3 * D), f32),
        'b_mod': 0.01 * nrm(ks[6], (DEPTH, 3 * D), f32),
        'ln_g': 1.0 + 0.02 * nrm(ks[7], (DEPTH, D), f32),
        'ln_b': 0.02 * nrm(ks[8], (DEPTH, D), f32),
        'w_in_even': D ** -0.5 * nrm(ks[9], (N_EVEN, D, IN_EVEN), f32),
        'conv_a_w': CONV_A ** -0.5 * nrm(ks[10], (N_EVEN, CONV_A, XBC_A), f32),
        'conv_a_b': 0.02 * nrm(ks[12], (N_EVEN, XBC_A), f32),
        'a_log': jnp.log(jax.random.uniform(ks[13], (N_EVEN, 2, N_HEADS_A), minval=1.0, maxval=16.0)),
        'dt_bias': dt0 + jnp.log(-jnp.expm1(-dt0)),
        'd_skip': 1.0 + 0.1 * nrm(ks[14], (N_EVEN, N_HEADS_A), f32),
        'norm_a_g': 1.0 + 0.02 * nrm(ks[15], (N_EVEN, D_A), f32),
        'conv_b_w': CONV_B ** -0.5 * nrm(ks[16], (N_EVEN, CONV_B, D_B), f32),
        'w_out_even': BETA * (D_A + D_B) ** -0.5 * nrm(ks[17], (N_EVEN, D_A + D_B, D), f32),
        'w_in_odd': D ** -0.5 * nrm(ks[18], (N_ODD, D, IN_ODD), f32),
        'w_pool': D_POOL_GRP ** -0.5 * nrm(ks[19], (N_ODD, N_POOL, D_POOL_GRP, D_POOL_GRP), f32),
        'pool_scale': 1.0 + 0.1 * nrm(ks[20], (N_ODD, D_C), f32),
        'w_out_odd': BETA * D_C ** -0.5 * nrm(ks[21], (N_ODD, D_C, D), f32),
    }


def reference(x_prompt, x_sample, state_ssd, c, c_ctx, w_mod, b_mod, ln_g, ln_b, w_in_even, conv_a_w,
              conv_a_b, a_log, dt_bias, d_skip, norm_a_g, conv_b_w, w_out_even, w_in_odd, w_pool,
              pool_scale, w_out_odd):
    h0_ctx = jnp.zeros((x_prompt.shape[0], N_EVEN, 2, N_HEADS_A, HEADDIM, D_STATE), dtype=x_prompt.dtype)
    y_prompt, new_state_ssd = trunk(x_prompt, c_ctx[None, :], h0_ctx, w_mod, b_mod, ln_g, ln_b, w_in_even,
                                    conv_a_w, conv_a_b, a_log, dt_bias, d_skip, norm_a_g, conv_b_w,
                                    w_out_even, w_in_odd, w_pool, pool_scale, w_out_odd)
    L = x_sample.shape[1]
    xs = x_sample + pos_embed_2d(L, x_sample.shape[2]).astype(x_sample.dtype)[None]
    y_sample, _ = trunk(xs, c, state_ssd, w_mod, b_mod, ln_g, ln_b, w_in_even, conv_a_w, conv_a_b,
                        a_log, dt_bias, d_skip, norm_a_g, conv_b_w, w_out_even, w_in_odd, w_pool,
                        pool_scale, w_out_odd)
    return (y_prompt, y_sample, new_state_ssd)
```

```cpp
#include <hip/hip_runtime.h>
#include <cstdint>
#include <cstdio>

typedef unsigned short bf16_t;
typedef short bf16x8 __attribute__((ext_vector_type(8)));
typedef float f32x4 __attribute__((ext_vector_type(4)));
typedef unsigned u32x4 __attribute__((ext_vector_type(4)));
typedef unsigned u32x2 __attribute__((ext_vector_type(2)));

constexpr int D = 1024, NCTX_B = 16, LCTX = 256, NSMP_B = 8, LSMP = 1024;
constexpr int NCTX = NCTX_B * LCTX;
constexpr int NTOK = NCTX + NSMP_B * LSMP;
constexpr int NH = 16, HD = 64, NG = 4, DS = 128;
constexpr int IN_EVEN = 7200, NEV = 7424;
constexpr int PLD = 5120;
constexpr int PC_Z = 0, PC_GT = 1024, PC_XBC = 2048, PC_CH = 4096;
constexpr int VLD = 4096;
constexpr int NBI = 9;
constexpr float ALPHA = 1.6817928305074290f;
constexpr float LN_EPS = 1e-5f, RMS_EPS = 1e-5f;

constexpr size_t MiB = 1u << 20;
constexpr size_t WS_CTL = 0;
constexpr size_t WS_MOD = 1 * MiB;
constexpr size_t WS_DT = 2 * MiB;
constexpr size_t WS_SSQ = 4 * MiB;
constexpr size_t WS_WIE = 5 * MiB;
constexpr size_t WS_WOE = 34 * MiB;
constexpr size_t WS_WIO = 42 * MiB;
constexpr size_t WS_WOO = 58 * MiB;
constexpr size_t WS_WPT = 66 * MiB;
constexpr size_t WS_WNAT = 70 * MiB;
constexpr size_t WS_U = 78 * MiB;
constexpr size_t WS_P = 102 * MiB;
constexpr size_t WS_END = 222 * MiB;

__device__ __forceinline__ unsigned f2bf(float f) { unsigned u = __builtin_bit_cast(unsigned, f); return (u + 0x7fffu + ((u >> 16) & 1u)) >> 16; }
__device__ __forceinline__ unsigned pk2(float lo, float hi) { return f2bf(lo) | (f2bf(hi) << 16); }
__device__ __forceinline__ float bf2f(unsigned short h) { return __builtin_bit_cast(float, (unsigned)h << 16); }
__device__ __forceinline__ float bflo(unsigned w) { return __builtin_bit_cast(float, w << 16); }
__device__ __forceinline__ float bfhi(unsigned w) { return __builtin_bit_cast(float, w & 0xffff0000u); }
__device__ __forceinline__ float siluf(float x) { return x / (1.f + __expf(-x)); }
__device__ __forceinline__ float softplusf(float x) { return x > 20.f ? x : log1pf(__expf(x)); }
__device__ __forceinline__ int row_bi(int row) { return row < NCTX ? 0 : 1 + ((row - NCTX) >> 10); }

__device__ __forceinline__ int ie_srccol(int n) {
    if (n < 1024) return n;
    if (n < 3072) return n;
    if (n < 7168) { const int t = (n - 3072) >> 8, x = (n - 3072) & 255;
        const int q = ((x >> 7) << 1) | ((x >> 4) & 1), ch = (((x >> 5) & 3) << 4) | (x & 15);
        return 3104 + 1024 * q + 64 * t + ch; }
    if (n < 7200) return 3072 + (n - 7168);
    return -1;
}

__global__ void __launch_bounds__(256) k_transpose(const float* __restrict__ src, int lds_, int K, bf16_t* __restrict__ dst, int mode, int coff) {
    __shared__ float tile[64][33];
    const int k0 = blockIdx.x * 64, n0 = blockIdx.y * 32, t = threadIdx.x;
    { const int nl = t & 31, n = n0 + nl; const int sc = mode == 1 ? ie_srccol(n) : n + coff;
#pragma unroll
      for (int i = 0; i < 8; ++i) { const int kl = (t >> 5) + 8 * i; tile[kl][nl] = sc >= 0 ? src[(size_t)(k0 + kl) * lds_ + sc] : 0.f; } }
    __syncthreads();
    { const int c = t & 7, nl = t >> 3; u32x4 o;
      o.x = pk2(tile[8 * c + 0][nl], tile[8 * c + 1][nl]); o.y = pk2(tile[8 * c + 2][nl], tile[8 * c + 3][nl]);
      o.z = pk2(tile[8 * c + 4][nl], tile[8 * c + 5][nl]); o.w = pk2(tile[8 * c + 6][nl], tile[8 * c + 7][nl]);
      *(u32x4*)(dst + (size_t)(n0 + nl) * K + k0 + 8 * c) = o; }
}
__global__ void __launch_bounds__(256) k_convert(const float* __restrict__ src, int scols, bf16_t* __restrict__ dst, int dcols, int rows) {
    const size_t i = (size_t)blockIdx.x * 256 + threadIdx.x; const size_t n4 = (size_t)rows * dcols / 4; if (i >= n4) return;
    const int r = (int)(i / (dcols / 4)), c = (int)(i % (dcols / 4)) * 4; const f32x4 v = *(const f32x4*)(src + (size_t)r * scols + c);
    u32x2 o; o.x = pk2(v[0], v[1]); o.y = pk2(v[2], v[3]); *(u32x2*)(dst + (size_t)r * dcols + c) = o;
}
__global__ void __launch_bounds__(512) k_mod(const float* __restrict__ c, const float* __restrict__ cctx, const float* __restrict__ wmod, const float* __restrict__ bmod, float* __restrict__ mod) {
    __shared__ float sc[NBI][1024]; __shared__ float red[8][NBI][64];
    const int l = blockIdx.y, n = blockIdx.x * 64 + (threadIdx.x & 63), w = threadIdx.x >> 6;
    for (int i = threadIdx.x; i < NBI * 1024; i += 512) { const int bi = i >> 10, k = i & 1023; const float v = bi == 0 ? cctx[k] : c[(bi - 1) * 1024 + k]; sc[bi][k] = siluf(v); }
    __syncthreads();
    float acc[NBI];
#pragma unroll
    for (int b = 0; b < NBI; ++b) acc[b] = 0.f;
    const float* wp = wmod + (size_t)l * 1024 * 3072 + n;
    for (int k = w * 128; k < w * 128 + 128; ++k) { const float wv = wp[(size_t)k * 3072];
#pragma unroll
        for (int b = 0; b < NBI; ++b) acc[b] += sc[b][k] * wv; }
#pragma unroll
    for (int b = 0; b < NBI; ++b) red[w][b][threadIdx.x & 63] = acc[b];
    __syncthreads();
    for (int i = threadIdx.x; i < NBI * 64; i += 512) { const int b = i >> 6, nl = i & 63; float s = 0.f;
#pragma unroll
        for (int ww = 0; ww < 8; ++ww) s += red[ww][b][nl];
        const int nn = blockIdx.x * 64 + nl; mod[((size_t)l * NBI + b) * 3072 + nn] = s + bmod[l * 3072 + nn]; }
}
__global__ void __launch_bounds__(256) k_xinit(const float* __restrict__ xp, const float* __restrict__ xs, const float* __restrict__ mod, float* __restrict__ X, bf16_t* __restrict__ U) {
    const int row = blockIdx.x, c0 = threadIdx.x * 4; f32x4 v;
    if (row < NCTX) v = *(const f32x4*)(xp + (size_t)row * D + c0);
    else { v = *(const f32x4*)(xs + (size_t)(row - NCTX) * D + c0); const int t = (row - NCTX) & 1023; const float pr = (float)(t >> 6), pc = (float)(t & 63);
#pragma unroll
        for (int e = 0; e < 4; ++e) { const int cc = c0 + e, k = cc & 255, sel = cc >> 8; const float om = 1.0f / powf(10000.0f, (float)k / 256.0f); const float a = ((sel & 2) ? pc : pr) * om; v[e] += (sel & 1) ? cosf(a) : sinf(a); } }
    *(f32x4*)(X + (size_t)row * D + c0) = v;
    const float* m = mod + (size_t)row_bi(row) * 3072; const f32x4 sh = *(const f32x4*)(m + c0), scl = *(const f32x4*)(m + 1024 + c0);
    u32x2 o; o.x = pk2(v[0] * (1.f + scl[0]) + sh[0], v[1] * (1.f + scl[1]) + sh[1]); o.y = pk2(v[2] * (1.f + scl[2]) + sh[2], v[3] * (1.f + scl[3]) + sh[3]);
    *(u32x2*)(U + (size_t)row * D + c0) = o;
}

enum { EPI_INEVEN = 0, EPI_BF16 = 1, EPI_COMPOSE = 2 };
struct GemmArgs { const bf16_t* A; const bf16_t* Bt; bf16_t* O; float* DT; const float* rs; int lda, ldb, K, ldo; };
template <int EPI>
__global__ void __launch_bounds__(256) k_gemm(GemmArgs g) {
    const int lane = threadIdx.x & 63, w = threadIdx.x >> 6, fr = lane & 15, fq = lane >> 4;
    const int row = blockIdx.y * 64 + w * 16 + fr, col0 = blockIdx.x * 256;
    f32x4 acc[16];
#pragma unroll
    for (int i = 0; i < 16; ++i) acc[i] = (f32x4){0.f, 0.f, 0.f, 0.f};
    const bf16_t* ap = g.A + (size_t)row * g.lda + fq * 8; const bf16_t* bp = g.Bt + (size_t)(col0 + fr) * g.ldb + fq * 8;
    for (int k = 0; k < g.K; k += 32) {
        const bf16x8 a = *(const bf16x8*)(ap + k);
#pragma unroll
        for (int nt = 0; nt < 16; ++nt) { const bf16x8 b = *(const bf16x8*)(bp + (size_t)nt * 16 * g.ldb + k); acc[nt] = __builtin_amdgcn_mfma_f32_16x16x32_bf16(b, a, acc[nt], 0, 0, 0); }
    }
    if (EPI == EPI_BF16 || EPI == EPI_COMPOSE) {
        const float s = EPI == EPI_COMPOSE ? g.rs[row] : 1.f;
#pragma unroll
        for (int nt = 0; nt < 16; ++nt) { u32x2 o; o.x = pk2(acc[nt][0] * s, acc[nt][1] * s); o.y = pk2(acc[nt][2] * s, acc[nt][3] * s); *(u32x2*)(g.O + (size_t)row * g.ldo + col0 + 16 * nt + 4 * fq) = o; }
    } else {
        const int pn = blockIdx.x; bf16_t* prow = g.O + (size_t)row * PLD;
        if (pn < 12) { const int cb = pn < 4 ? PC_Z + 256 * pn : PC_XBC + 256 * (pn - 4);
#pragma unroll
            for (int nt = 0; nt < 16; ++nt) { u32x2 o; o.x = pk2(acc[nt][0], acc[nt][1]); o.y = pk2(acc[nt][2], acc[nt][3]); *(u32x2*)(prow + cb + 16 * nt + 4 * fq) = o; }
        } else if (pn < 28) { const int kt = pn - 12;
#pragma unroll
            for (int c4 = 0; c4 < 4; ++c4) { const f32x4 gv = acc[2 * c4], bg = acc[2 * c4 + 1], cg = acc[8 + 2 * c4], hv = acc[9 + 2 * c4]; const int ch = 64 * kt + 16 * c4 + 4 * fq;
                u32x2 o; o.x = pk2(bg[0] * siluf(gv[0]), bg[1] * siluf(gv[1])); o.y = pk2(bg[2] * siluf(gv[2]), bg[3] * siluf(gv[3])); *(u32x2*)(prow + PC_GT + ch) = o;
                u32x2 m; m.x = pk2(cg[0] * hv[0], cg[1] * hv[1]); m.y = pk2(cg[2] * hv[2], cg[3] * hv[3]); *(u32x2*)(prow + PC_CH + ch) = m; }
        } else {
#pragma unroll
            for (int nt = 0; nt < 2; ++nt) *(f32x4*)(g.DT + (size_t)row * 32 + 16 * nt + 4 * fq) = acc[nt];
        }
    }
}

struct OutArgs { const bf16_t* A; const bf16_t* Bt; const float* ssq; float* X; bf16_t* U; const float* mod; const float* modn; const float* lng; const float* lnb; int lda, pad; };
template <bool EVEN>
__global__ void __launch_bounds__(256) k_outproj(OutArgs g) {
    __shared__ float red[2][4][16];
    const int lane = threadIdx.x & 63, w = threadIdx.x >> 6, fr = lane & 15, fq = lane >> 4;
    const int row = blockIdx.x * 16 + fr, col0 = w * 256;
    f32x4 acc[16];
#pragma unroll
    for (int i = 0; i < 16; ++i) acc[i] = (f32x4){0.f, 0.f, 0.f, 0.f};
    float rr = 1.f;
    if (EVEN) { float s = 0.f;
#pragma unroll
        for (int h = 0; h < 16; ++h) s += g.ssq[(size_t)row * 16 + h];
        rr = 1.0f / sqrtf(s * (1.0f / 1024.0f) + RMS_EPS); }
    const bf16_t* ap = g.A + (size_t)row * g.lda + fq * 8; const bf16_t* bp = g.Bt + (size_t)(col0 + fr) * 2048 + fq * 8;
    for (int k = 0; k < 2048; k += 32) {
        if (EVEN && k == 1024) {
#pragma unroll
            for (int nt = 0; nt < 16; ++nt) acc[nt] = acc[nt] * rr; }
        const bf16x8 a = *(const bf16x8*)(ap + k);
#pragma unroll
        for (int nt = 0; nt < 16; ++nt) { const bf16x8 b = *(const bf16x8*)(bp + (size_t)nt * 16 * 2048 + k); acc[nt] = __builtin_amdgcn_mfma_f32_16x16x32_bf16(b, a, acc[nt], 0, 0, 0); }
    }
    const int bi = row_bi(row); const float* md = g.mod + (size_t)bi * 3072; float* xr = g.X + (size_t)row * D;
    float s = 0.f;
#pragma unroll
    for (int nt = 0; nt < 16; ++nt) { const int c = col0 + 16 * nt + 4 * fq; const f32x4 xv = *(const f32x4*)(xr + c), gt = *(const f32x4*)(md + 2048 + c);
        acc[nt] = ALPHA * xv + (1.f + gt) * acc[nt]; s += (acc[nt][0] + acc[nt][1]) + (acc[nt][2] + acc[nt][3]); }
    s += __shfl_xor(s, 16); s += __shfl_xor(s, 32);
    if (fq == 0) red[0][w][fr] = s;
    __syncthreads();
    const float mean = (red[0][0][fr] + red[0][1][fr] + red[0][2][fr] + red[0][3][fr]) * (1.0f / 1024.0f);
    float q = 0.f;
#pragma unroll
    for (int nt = 0; nt < 16; ++nt) { const f32x4 d = acc[nt] - mean; q += (d[0] * d[0] + d[1] * d[1]) + (d[2] * d[2] + d[3] * d[3]); }
    q += __shfl_xor(q, 16); q += __shfl_xor(q, 32);
    if (fq == 0) red[1][w][fr] = q;
    __syncthreads();
    const float rstd = 1.0f / sqrtf((red[1][0][fr] + red[1][1][fr] + red[1][2][fr] + red[1][3][fr]) * (1.0f / 1024.0f) + LN_EPS);
    const float* mn = g.modn ? g.modn + (size_t)bi * 3072 : nullptr;
#pragma unroll
    for (int nt = 0; nt < 16; ++nt) { const int c = col0 + 16 * nt + 4 * fq; const f32x4 gg = *(const f32x4*)(g.lng + c), bb = *(const f32x4*)(g.lnb + c);
        const f32x4 o = (acc[nt] - mean) * rstd * gg + bb; *(f32x4*)(xr + c) = o;
        if (mn) { const f32x4 sh = *(const f32x4*)(mn + c), sc = *(const f32x4*)(mn + 1024 + c); const f32x4 u = o * (1.f + sc) + sh; u32x2 ub; ub.x = pk2(u[0], u[1]); ub.y = pk2(u[2], u[3]); *(u32x2*)(g.U + (size_t)row * D + c) = ub; } }
}

struct SsdArgs { bf16_t* P; const float* DT; bf16_t* stash; float* ssq; const float* state_in; float* state_out; const float* convw; const float* convb; const float* alog; const float* dtb; const float* dsk; const float* ng; int j, pad; };
__global__ void __launch_bounds__(256) k_ssd(SsdArgs g) {
    __shared__ float sx[32][64], sB[32][128], sC[32][128], sy[32][64], sdt[32];
    const int tid = threadIdx.x, h = blockIdx.x & 15, ba = blockIdx.x >> 4, grp = h >> 2;
    const bool ctx = ba < NCTX_B; const int L = ctx ? LCTX : LSMP, rbase = ctx ? ba * LCTX : NCTX + (ba - NCTX_B) * LSMP;
    const int p = tid >> 2, nq = tid & 3;
    for (int dir = 0; dir < 2; ++dir) {
        const float A = -__expf(g.alog[(g.j * 2 + dir) * 16 + h]), dbias = g.dtb[(g.j * 2 + dir) * 16 + h], dsk = g.dsk[g.j * 16 + h];
        float hs[32];
        if (ctx) {
#pragma unroll
            for (int n = 0; n < 32; ++n) hs[n] = 0.f;
        } else { const float* sp = g.state_in + ((((size_t)(ba - NCTX_B) * 2 + g.j) * 2 + dir) * 16 + h) * (64 * 128) + p * 128 + nq * 32;
#pragma unroll
            for (int n = 0; n < 32; ++n) hs[n] = sp[n]; }
        for (int blk = 0; blk < L / 32; ++blk) {
            const int t0 = dir == 0 ? blk * 32 : L - 32 - blk * 32;
            __syncthreads();
            for (int i = tid; i < 32 * 320; i += 256) { const int r = i / 320, cc = i % 320; const int t = t0 + r;
                const int xc = cc < 64 ? h * 64 + cc : (cc < 192 ? 1024 + grp * 128 + (cc - 64) : 1536 + grp * 128 + (cc - 192));
                float a = g.convb[g.j * 2048 + xc];
#pragma unroll
                for (int k = 0; k < 3; ++k) { const int tt = t - 1 + k; if (tt >= 0 && tt < L) a += g.convw[(g.j * 3 + k) * 2048 + xc] * bf2f(g.P[(size_t)(rbase + tt) * PLD + PC_XBC + xc]); }
                a = siluf(a);
                if (cc < 64) sx[r][cc] = a; else if (cc < 192) sB[r][cc - 64] = a; else sC[r][cc - 192] = a; }
            if (tid < 32) sdt[tid] = softplusf(g.DT[(size_t)(rbase + t0 + tid) * 32 + dir * 16 + h] + dbias);
            __syncthreads();
            for (int s = 0; s < 32; ++s) { const int r = dir == 0 ? s : 31 - s; const float dtv = sdt[r], da = __expf(dtv * A), xd = dtv * sx[r][p]; float y = 0.f;
#pragma unroll
                for (int n = 0; n < 32; ++n) { hs[n] = hs[n] * da + xd * sB[r][nq * 32 + n]; y += sC[r][nq * 32 + n] * hs[n]; }
                y += __shfl_xor(y, 1); y += __shfl_xor(y, 2);
                if (nq == 0) sy[r][p] = y; }
            __syncthreads();
            if (dir == 0) { for (int i = tid; i < 32 * 64; i += 256) { const int r = i >> 6, pp = i & 63; g.stash[(size_t)(rbase + t0 + r) * D + h * 64 + pp] = (bf16_t)f2bf(sy[r][pp] + dsk * sx[r][pp]); } }
            else {
                for (int i = tid; i < 32 * 64; i += 256) { const int r = i >> 6, pp = i & 63; const size_t row = rbase + t0 + r;
                    const float y = sy[r][pp] + bf2f(g.stash[row * D + h * 64 + pp]); const float z = bf2f(g.P[row * PLD + PC_Z + h * 64 + pp]); sy[r][pp] = y * siluf(z); }
                __syncthreads();
                if (tid < 32) { float s2 = 0.f; for (int pp = 0; pp < 64; ++pp) s2 += sy[tid][pp] * sy[tid][pp]; g.ssq[(size_t)(rbase + t0 + tid) * 16 + h] = s2; }
                for (int i = tid; i < 32 * 64; i += 256) { const int r = i >> 6, pp = i & 63; g.P[(size_t)(rbase + t0 + r) * PLD + PC_Z + h * 64 + pp] = (bf16_t)f2bf(sy[r][pp] * g.ng[g.j * 1024 + h * 64 + pp]); }
            }
        }
        if (ctx) { float* sp = g.state_out + ((((size_t)ba * 2 + g.j) * 2 + dir) * 16 + h) * (64 * 128) + p * 128 + nq * 32;
#pragma unroll
            for (int n = 0; n < 32; ++n) sp[n] = hs[n]; }
    }
}
__global__ void __launch_bounds__(256) k_mixb(bf16_t* __restrict__ P, const float* __restrict__ cw, int j) {
    const int row = blockIdx.x, c0 = threadIdx.x * 4; const bool ctx = row < NCTX; const int t = ctx ? (row & 255) : ((row - NCTX) & 1023), L = ctx ? LCTX : LSMP;
    float a[4] = {0.f, 0.f, 0.f, 0.f};
#pragma unroll
    for (int k = 0; k < 3; ++k) { const int tt = t - 1 + k; if (tt < 0 || tt >= L) continue; const u32x2 v = *(const u32x2*)(P + (size_t)(row - 1 + k) * PLD + PC_CH + c0); const f32x4 wv = *(const f32x4*)(cw + (size_t)(j * 3 + k) * 1024 + c0);
        a[0] += wv[0] * bflo(v.x); a[1] += wv[1] * bfhi(v.x); a[2] += wv[2] * bflo(v.y); a[3] += wv[3] * bfhi(v.y); }
    bf16_t* gp = P + (size_t)row * PLD + PC_GT + c0; const u32x2 gv = *(const u32x2*)gp; u32x2 o; o.x = pk2(bflo(gv.x) * a[0], bfhi(gv.x) * a[1]); o.y = pk2(bflo(gv.y) * a[2], bfhi(gv.y) * a[3]); *(u32x2*)gp = o;
}
__global__ void __launch_bounds__(256) k_pool(bf16_t* __restrict__ V) {
    const int row = blockIdx.x, c0 = threadIdx.x * 8; const bool ctx = row < NCTX; const int t = ctx ? (row & 255) : ((row - NCTX) & 1023), L = ctx ? LCTX : LSMP;
    const int w = 2 << (c0 >> 9); int lo = t - w / 2, hi = t + w - w / 2; lo = lo < 0 ? 0 : lo; hi = hi > L ? L : hi;
    float s[8] = {0.f, 0.f, 0.f, 0.f, 0.f, 0.f, 0.f, 0.f};
    for (int tt = lo; tt < hi; ++tt) { const u32x4 v = *(const u32x4*)(V + (size_t)(row - t + tt) * VLD + c0);
        s[0] += bflo(v.x); s[1] += bfhi(v.x); s[2] += bflo(v.y); s[3] += bfhi(v.y); s[4] += bflo(v.z); s[5] += bfhi(v.z); s[6] += bflo(v.w); s[7] += bfhi(v.w); }
    const float inv = 1.0f / (float)(hi - lo); const u32x4 v = *(const u32x4*)(V + (size_t)row * VLD + c0); bf16_t* gp = V + (size_t)row * VLD + 2048 + c0; const u32x4 gv = *(const u32x4*)gp;
    const float vv[8] = {bflo(v.x), bfhi(v.x), bflo(v.y), bfhi(v.y), bflo(v.z), bfhi(v.z), bflo(v.w), bfhi(v.w)};
    const float gg[8] = {bflo(gv.x), bfhi(gv.x), bflo(gv.y), bfhi(gv.y), bflo(gv.z), bfhi(gv.z), bflo(gv.w), bfhi(gv.w)};
    float o[8];
#pragma unroll
    for (int e = 0; e < 8; ++e) o[e] = (s[e] * inv - vv[e]) * siluf(gg[e]);
    u32x4 ov; ov.x = pk2(o[0], o[1]); ov.y = pk2(o[2], o[3]); ov.z = pk2(o[4], o[5]); ov.w = pk2(o[6], o[7]); *(u32x4*)gp = ov;
}

extern "C" void kernel_launch(void* const* d_in, const int* in_sizes, int n_in, void* d_out, int out_size, void* d_ws, size_t ws_size, hipStream_t stream) {
    if (n_in != 22 || ws_size < WS_END) { fprintf(stderr, "kernel_launch: unexpected n_in %d / ws_size %zu\n", n_in, ws_size); return; }
    const float* x_prompt = (const float*)d_in[0]; const float* x_sample = (const float*)d_in[1]; const float* state_ssd = (const float*)d_in[2];
    const float* c = (const float*)d_in[3]; const float* c_ctx = (const float*)d_in[4]; const float* w_mod = (const float*)d_in[5]; const float* b_mod = (const float*)d_in[6];
    const float* ln_g = (const float*)d_in[7]; const float* ln_b = (const float*)d_in[8]; const float* w_in_even = (const float*)d_in[9];
    const float* conv_a_w = (const float*)d_in[10]; const float* conv_a_b = (const float*)d_in[11]; const float* a_log = (const float*)d_in[12]; const float* dt_bias = (const float*)d_in[13];
    const float* d_skip = (const float*)d_in[14]; const float* norm_a_g = (const float*)d_in[15]; const float* conv_b_w = (const float*)d_in[16]; const float* w_out_even = (const float*)d_in[17];
    const float* w_in_odd = (const float*)d_in[18]; const float* w_pool = (const float*)d_in[19]; const float* pool_scale = (const float*)d_in[20]; const float* w_out_odd = (const float*)d_in[21];
    unsigned char* ws = (unsigned char*)d_ws; float* X = (float*)d_out; float* state_out = X + (size_t)NTOK * D;
    float* MOD = (float*)(ws + WS_MOD); float* DT = (float*)(ws + WS_DT); float* SSQ = (float*)(ws + WS_SSQ);
    bf16_t* WIE = (bf16_t*)(ws + WS_WIE); bf16_t* WOE = (bf16_t*)(ws + WS_WOE); bf16_t* WIO = (bf16_t*)(ws + WS_WIO); bf16_t* WOO = (bf16_t*)(ws + WS_WOO);
    bf16_t* WPT = (bf16_t*)(ws + WS_WPT); bf16_t* WNAT = (bf16_t*)(ws + WS_WNAT); bf16_t* U = (bf16_t*)(ws + WS_U); bf16_t* P = (bf16_t*)(ws + WS_P);

    for (int j = 0; j < 2; ++j) {
        k_transpose<<<dim3(1024 / 64, NEV / 32), 256, 0, stream>>>(w_in_even + (size_t)j * 1024 * IN_EVEN, IN_EVEN, 1024, WIE + (size_t)j * NEV * 1024, 1, 0);
        k_transpose<<<dim3(2048 / 64, 1024 / 32), 256, 0, stream>>>(w_out_even + (size_t)j * 2048 * 1024, 1024, 2048, WOE + (size_t)j * 1024 * 2048, 0, 0);
        k_transpose<<<dim3(1024 / 64, 2048 / 32), 256, 0, stream>>>(w_in_odd + (size_t)j * 1024 * 4096, 4096, 1024, WIO + (size_t)j * 4096 * 1024 + (size_t)2048 * 1024, 0, 2048);
        k_transpose<<<dim3(2048 / 64, 1024 / 32), 256, 0, stream>>>(w_out_odd + (size_t)j * 2048 * 1024, 1024, 2048, WOO + (size_t)j * 1024 * 2048, 0, 0);
        for (int k = 0; k < 4; ++k) k_transpose<<<dim3(512 / 64, 512 / 32), 256, 0, stream>>>(w_pool + (size_t)(j * 4 + k) * 512 * 512, 512, 512, WPT + (size_t)(j * 4 + k) * 512 * 512, 0, 0);
        k_convert<<<(1024 * 2048 / 4 + 255) / 256, 256, 0, stream>>>(w_in_odd + (size_t)j * 1024 * 4096, 4096, WNAT + (size_t)j * 1024 * 2048, 2048, 1024);
    }
    k_mod<<<dim3(48, 4), 512, 0, stream>>>(c, c_ctx, w_mod, b_mod, MOD);
    k_xinit<<<NTOK, 256, 0, stream>>>(x_prompt, x_sample, MOD, X, U);
    for (int j = 0; j < 2; ++j) for (int k = 0; k < 4; ++k) {
        GemmArgs g{WPT + (size_t)(j * 4 + k) * 512 * 512, WNAT + (size_t)j * 1024 * 2048 + 512 * k, WIO + (size_t)j * 4096 * 1024 + (size_t)512 * k * 1024, nullptr, pool_scale + j * 2048 + 512 * k, 512, 2048, 512, 1024};
        k_gemm<EPI_COMPOSE><<<dim3(1024 / 256, 512 / 64), 256, 0, stream>>>(g);
    }
    for (int i = 0; i < 4; ++i) {
        const int j = i >> 1; const float* modi = MOD + (size_t)i * NBI * 3072; const float* modn = i < 3 ? MOD + (size_t)(i + 1) * NBI * 3072 : nullptr;
        if ((i & 1) == 0) {
            GemmArgs g{U, WIE + (size_t)j * NEV * 1024, P, DT, nullptr, 1024, 1024, 1024, PLD};
            k_gemm<EPI_INEVEN><<<dim3(NEV / 256, NTOK / 64), 256, 0, stream>>>(g);
            SsdArgs s{P, DT, U, SSQ, state_ssd, state_out, conv_a_w, conv_a_b, a_log, dt_bias, d_skip, norm_a_g, j, 0};
            k_ssd<<<(NCTX_B + NSMP_B) * 16, 256, 0, stream>>>(s);
            k_mixb<<<NTOK, 256, 0, stream>>>(P, conv_b_w, j);
            OutArgs o{P, WOE + (size_t)j * 1024 * 2048, SSQ, X, U, modi, modn, ln_g + i * 1024, ln_b + i * 1024, PLD, 0};
            k_outproj<true><<<NTOK / 16, 256, 0, stream>>>(o);
        } else {
            GemmArgs g{U, WIO + (size_t)j * 4096 * 1024, P, nullptr, nullptr, 1024, 1024, 1024, VLD};
            k_gemm<EPI_BF16><<<dim3(4096 / 256, NTOK / 64), 256, 0, stream>>>(g);
            k_pool<<<NTOK, 256, 0, stream>>>(P);
            OutArgs o{P + 2048, WOO + (size_t)j * 1024 * 2048, nullptr, X, U, modi, modn, ln_g + i * 1024, ln_b + i * 1024, VLD, 0};
            k_outproj<false><<<NTOK / 16, 256, 0, stream>>>(o);
        }
    }
}
```

```cpp
#include <hip/hip_runtime.h>
#include <cstdint>
#include <cstdio>

typedef unsigned short bf16_t;
typedef short bf16x8 __attribute__((ext_vector_type(8)));
typedef float f32x4 __attribute__((ext_vector_type(4)));
typedef unsigned u32x4 __attribute__((ext_vector_type(4)));
typedef unsigned u32x2 __attribute__((ext_vector_type(2)));

constexpr int D = 1024, NCTX_B = 16, LCTX = 256, NSMP_B = 8, LSMP = 1024;
constexpr int NCTX = NCTX_B * LCTX;
constexpr int NTOK = NCTX + NSMP_B * LSMP;
constexpr int NH = 16, HD = 64, NG = 4, DS = 128;
constexpr int IN_EVEN = 7200, NEV = 7424;
constexpr int PLD = 5120;
constexpr int PC_Z = 0, PC_GT = 1024, PC_XBC = 2048, PC_CH = 4096;
constexpr int VLD = 4096;
constexpr int NBI = 9;
constexpr float ALPHA = 1.6817928305074290f;
constexpr float LN_EPS = 1e-5f, RMS_EPS = 1e-5f;

constexpr size_t MiB = 1u << 20;
constexpr size_t WS_CTL = 0;
constexpr size_t WS_MOD = 1 * MiB;
constexpr size_t WS_DT = 2 * MiB;
constexpr size_t WS_SSQ = 4 * MiB;
constexpr size_t WS_WIE = 5 * MiB;
constexpr size_t WS_WOE = 34 * MiB;
constexpr size_t WS_WIO = 42 * MiB;
constexpr size_t WS_WOO = 58 * MiB;
constexpr size_t WS_WPT = 66 * MiB;
constexpr size_t WS_WNAT = 70 * MiB;
constexpr size_t WS_U = 78 * MiB;
constexpr size_t WS_P = 102 * MiB;
constexpr size_t WS_END = 222 * MiB;

__device__ __forceinline__ unsigned f2bf(float f) { unsigned u = __builtin_bit_cast(unsigned, f); return (u + 0x7fffu + ((u >> 16) & 1u)) >> 16; }
__device__ __forceinline__ unsigned pk2(float lo, float hi) { return f2bf(lo) | (f2bf(hi) << 16); }
__device__ __forceinline__ float bf2f(unsigned short h) { return __builtin_bit_cast(float, (unsigned)h << 16); }
__device__ __forceinline__ float bflo(unsigned w) { return __builtin_bit_cast(float, w << 16); }
__device__ __forceinline__ float bfhi(unsigned w) { return __builtin_bit_cast(float, w & 0xffff0000u); }
__device__ __forceinline__ float siluf(float x) { return x / (1.f + __expf(-x)); }
__device__ __forceinline__ float softplusf(float x) { return x > 20.f ? x : log1pf(__expf(x)); }
__device__ __forceinline__ int row_bi(int row) { return row < NCTX ? 0 : 1 + ((row - NCTX) >> 10); }

__device__ __forceinline__ int ie_srccol(int n) {
    if (n < 1024) return n;
    if (n < 3072) return n;
    if (n < 7168) { const int t = (n - 3072) >> 8, x = (n - 3072) & 255;
        const int q = ((x >> 7) << 1) | ((x >> 4) & 1), ch = (((x >> 5) & 3) << 4) | (x & 15);
        return 3104 + 1024 * q + 64 * t + ch; }
    if (n < 7200) return 3072 + (n - 7168);
    return -1;
}


#define LAS __attribute__((address_space(3)))
#define LDS_WAIT() asm volatile("s_waitcnt lgkmcnt(0)" ::: "memory")
constexpr int NTHR = 512;
constexpr int LDS_PHASE = 131072, LDSCTL_OFF = LDS_PHASE, MISC_OFF = LDSCTL_OFF + 320, LDS_BYTES = 147456;
constexpr size_t CTL_ZERO_BYTES = 64 * 1024;
constexpr int CW_BAR = 4096;

#define XB_TMO      128
#define XB_XCNT(j)  (256  + 64 * (j))
#define XB_XSUB(j)  (1280 + 64 * (j))
#define XB_XGEN(j)  (2304 + 64 * (j))
#define XB_TOP      3328
#define XB_TOPGEN   3392
#define XCD_BAR_WORDS 3456
#define XB_SPIN_CAP (1u << 22)
__device__ __forceinline__ unsigned xb_ld(unsigned* p)              { return __hip_atomic_load(p, __ATOMIC_RELAXED, __HIP_MEMORY_SCOPE_AGENT); }
__device__ __forceinline__ unsigned xb_add(unsigned* p, unsigned v) { return __hip_atomic_fetch_add(p, v, __ATOMIC_RELAXED, __HIP_MEMORY_SCOPE_AGENT); }
__device__ __forceinline__ unsigned xb_xcc_id() { return (unsigned)__builtin_amdgcn_s_getreg((3 << 11) | 20) & 0xFu; }
#define XB_SPIN(cond, bar) do { unsigned _sp = 0; while (cond) { __builtin_amdgcn_s_sleep(1); \
    if ((++_sp & 255u) == 0u) { if (xb_ld(&(bar)[XB_TMO])) break; if (_sp > XB_SPIN_CAP) { atomicAdd(&(bar)[XB_TMO], 1u); break; } } } } while (0)
struct XcdBarrier { unsigned* bar; unsigned x; volatile LAS unsigned* st; };
__device__ __forceinline__ XcdBarrier xcd_barrier_post(unsigned* bar, volatile LAS unsigned* st) {
    XcdBarrier b; b.bar = bar; b.x = xb_xcc_id(); b.st = st;
    if (threadIdx.x == 0) (void)xb_add(&bar[XB_XCNT(b.x)], 1u);
    return b;
}
__device__ __forceinline__ void xcd_barrier_complete(unsigned* bar, unsigned x, unsigned& nloc, unsigned& nx) {
    const unsigned G = gridDim.x * gridDim.y * gridDim.z;
    unsigned sum, cnt, mine, sp = 0u;
    for (;;) {
        sum = 0u; cnt = 0u; mine = 0u;
#pragma unroll
        for (unsigned j = 0; j < 16; ++j) { const unsigned c = xb_ld(&bar[XB_XCNT(j)]); sum += c; cnt += (c > 0u) ? 1u : 0u; mine = (j == x) ? c : mine; }
        if (sum == G) break;
        __builtin_amdgcn_s_sleep(1);
        if ((++sp & 255u) == 0u) { if (xb_ld(&bar[XB_TMO])) break; if (sp > XB_SPIN_CAP) { atomicAdd(&bar[XB_TMO], 1u); break; } }
    }
    nloc = mine > 0u ? mine : 1u; nx = cnt > 0u ? cnt : 1u;
}
__device__ __forceinline__ void xcd_barrier(const XcdBarrier& b) {
    asm volatile("s_waitcnt vmcnt(0)" ::: "memory");
    __syncthreads();
    if (threadIdx.x == 0) {
        unsigned* bar = b.bar;
        __builtin_amdgcn_s_waitcnt(0);
        unsigned nloc = b.st[0], nx = b.st[1];
        if (nloc == 0u) { xcd_barrier_complete(bar, b.x, nloc, nx); b.st[0] = nloc; b.st[1] = nx; }
        const unsigned old = xb_add(&bar[XB_XSUB(b.x)], 1u);
        const unsigned gen = old / nloc;
        if (old + 1u == (gen + 1u) * nloc) {
            __builtin_amdgcn_fence(__ATOMIC_RELEASE, "agent");
            asm volatile("s_waitcnt vmcnt(0)" ::: "memory");
            const unsigned og = xb_add(&bar[XB_TOP], 1u);
            const unsigned tg = og / nx;
            if (og + 1u == (tg + 1u) * nx) xb_add(&bar[XB_TOPGEN], 1u);
            else XB_SPIN(xb_ld(&bar[XB_TOPGEN]) == tg, bar);
            __builtin_amdgcn_fence(__ATOMIC_ACQUIRE, "agent");
            xb_add(&bar[XB_XGEN(b.x)], 1u);
            asm volatile("s_waitcnt vmcnt(0)" ::: "memory");
        } else {
            XB_SPIN(xb_ld(&bar[XB_XGEN(b.x)]) == gen, bar);
            __builtin_amdgcn_fence(__ATOMIC_ACQUIRE, "agent");
            asm volatile("s_waitcnt vmcnt(0)" ::: "memory");
        }
    }
    __syncthreads();
}

__device__ __forceinline__ void tr_item(const float* __restrict__ src, int sld, int K, bf16_t* __restrict__ dst, int mode, int coff, int kb, int nb, float* scr, int lane) {
    const int k0 = 64 * kb, n0 = 32 * nb; const int n = n0 + (lane & 31); const int sc = mode == 1 ? ie_srccol(n) : n + coff;
#pragma unroll 8
    for (int i = 0; i < 32; ++i) { const int kk = 2 * i + (lane >> 5); scr[kk * 33 + (lane & 31)] = sc >= 0 ? src[(size_t)(k0 + kk) * sld + sc] : 0.f; }
    LDS_WAIT();
    const int c = lane & 7;
#pragma unroll
    for (int j = 0; j < 4; ++j) { const int nl = (lane >> 3) + 8 * j; const float* s = scr + (8 * c) * 33 + nl;
        u32x4 o; o.x = pk2(s[0 * 33], s[1 * 33]); o.y = pk2(s[2 * 33], s[3 * 33]); o.z = pk2(s[4 * 33], s[5 * 33]); o.w = pk2(s[6 * 33], s[7 * 33]);
        *(u32x4*)(dst + (size_t)(n0 + nl) * K + k0 + 8 * c) = o; }
    LDS_WAIT();
}
struct Ptrs {
    const float *x_prompt, *x_sample, *state_ssd, *c, *c_ctx, *w_mod, *b_mod, *ln_g, *ln_b, *w_in_even, *conv_a_w, *conv_a_b, *a_log, *dt_bias, *d_skip, *norm_a_g, *conv_b_w, *w_out_even, *w_in_odd, *w_pool, *pool_scale, *w_out_odd;
    float *X, *state_out, *MOD, *DT, *SSQ; bf16_t *WIE, *WOE, *WIO, *WOO, *WPT, *WNAT, *U, *P;
};
constexpr int TR_PER_J = 3712 + 3 * 1024 + 4 * 128, TR_ITEMS = 2 * TR_PER_J;
__device__ __forceinline__ void phase0a(const Ptrs& q, unsigned char* lds) {
    const int tid = threadIdx.x, lane = tid & 63, wave = tid >> 6, gw = blockIdx.x * 8 + wave, NGW = gridDim.x * 8;
    float* scr = (float*)(lds + wave * 8704);
    for (int it = gw; it < TR_ITEMS; it += NGW) {
        const int j = it / TR_PER_J; int r = it % TR_PER_J;
        if (r < 3712) { tr_item(q.w_in_even + (size_t)j * 1024 * IN_EVEN, IN_EVEN, 1024, q.WIE + (size_t)j * NEV * 1024, 1, 0, r / 232, r % 232, scr, lane); continue; } r -= 3712;
        if (r < 1024) { tr_item(q.w_out_even + (size_t)j * 2048 * 1024, 1024, 2048, q.WOE + (size_t)j * 1024 * 2048, 0, 0, r / 32, r % 32, scr, lane); continue; } r -= 1024;
        if (r < 1024) { tr_item(q.w_in_odd + (size_t)j * 1024 * 4096, 4096, 1024, q.WIO + (size_t)j * 4096 * 1024 + (size_t)2048 * 1024, 0, 2048, r / 64, r % 64, scr, lane); continue; } r -= 1024;
        if (r < 1024) { tr_item(q.w_out_odd + (size_t)j * 2048 * 1024, 1024, 2048, q.WOO + (size_t)j * 1024 * 2048, 0, 0, r / 32, r % 32, scr, lane); continue; } r -= 1024;
        { const int k = r >> 7; r &= 127; tr_item(q.w_pool + (size_t)(j * 4 + k) * 512 * 512, 512, 512, q.WPT + (size_t)(j * 4 + k) * 512 * 512, 0, 0, r / 16, r % 16, scr, lane); }
    }
    for (size_t i = (size_t)blockIdx.x * NTHR + tid; i < (size_t)2 * 1024 * 2048 / 4; i += (size_t)gridDim.x * NTHR) {
        const int j = (int)(i >> 19), rr = (int)((i >> 9) & 1023), cc = (int)(i & 511) * 4; const f32x4 v = *(const f32x4*)(q.w_in_odd + ((size_t)j * 1024 + rr) * 4096 + cc);
        u32x2 o; o.x = pk2(v[0], v[1]); o.y = pk2(v[2], v[3]); *(u32x2*)(q.WNAT + ((size_t)j * 1024 + rr) * 2048 + cc) = o; }
    __syncthreads();
    float (*sc)[1024] = (float (*)[1024])lds; float (*red)[NBI][64] = (float (*)[NBI][64])(lds + NBI * 1024 * 4);
    for (int it = blockIdx.x; it < 192; it += gridDim.x) {
        const int l = it / 48, nb = it % 48, n = nb * 64 + lane;
        for (int i = tid; i < NBI * 1024; i += NTHR) { const int bi = i >> 10, k = i & 1023; const float v = bi == 0 ? q.c_ctx[k] : q.c[(bi - 1) * 1024 + k]; sc[bi][k] = siluf(v); }
        __syncthreads();
        float acc[NBI];
#pragma unroll
        for (int b = 0; b < NBI; ++b) acc[b] = 0.f;
        const float* wp = q.w_mod + (size_t)l * 1024 * 3072 + n;
        for (int k = wave * 128; k < wave * 128 + 128; ++k) { const float wv = wp[(size_t)k * 3072];
#pragma unroll
            for (int b = 0; b < NBI; ++b) acc[b] += sc[b][k] * wv; }
#pragma unroll
        for (int b = 0; b < NBI; ++b) red[wave][b][lane] = acc[b];
        __syncthreads();
        for (int i = tid; i < NBI * 64; i += NTHR) { const int b = i >> 6, nl = i & 63; float s = 0.f;
#pragma unroll
            for (int ww = 0; ww < 8; ++ww) s += red[ww][b][nl];
            const int nn = nb * 64 + nl; q.MOD[((size_t)l * NBI + b) * 3072 + nn] = s + q.b_mod[l * 3072 + nn]; }
        __syncthreads();
    }
}
__device__ __forceinline__ void xinit_rows(const Ptrs& q) {
    const int tid = threadIdx.x;
    for (int vb = blockIdx.x; vb < NTOK / 2; vb += gridDim.x) {
        const int row = 2 * vb + (tid >> 8), c0 = (tid & 255) * 4; f32x4 v;
        if (row < NCTX) v = *(const f32x4*)(q.x_prompt + (size_t)row * D + c0);
        else { v = *(const f32x4*)(q.x_sample + (size_t)(row - NCTX) * D + c0); const int t = (row - NCTX) & 1023; const float pr = (float)(t >> 6), pc = (float)(t & 63);
#pragma unroll
            for (int e = 0; e < 4; ++e) { const int cc = c0 + e, k = cc & 255, sel = cc >> 8; const float om = 1.0f / powf(10000.0f, (float)k / 256.0f); const float a = ((sel & 2) ? pc : pr) * om; v[e] += (sel & 1) ? cosf(a) : sinf(a); } }
        *(f32x4*)(q.X + (size_t)row * D + c0) = v;
        const float* m = q.MOD + (size_t)row_bi(row) * 3072; const f32x4 sh = *(const f32x4*)(m + c0), scl = *(const f32x4*)(m + 1024 + c0);
        u32x2 o; o.x = pk2(v[0] * (1.f + scl[0]) + sh[0], v[1] * (1.f + scl[1]) + sh[1]); o.y = pk2(v[2] * (1.f + scl[2]) + sh[2], v[3] * (1.f + scl[3]) + sh[3]);
        *(u32x2*)(q.U + (size_t)row * D + c0) = o;
    }
}

enum { EPI_INEVEN = 0, EPI_BF16 = 1, EPI_COMPOSE = 2 };
struct GemmArgs { const bf16_t* A; const bf16_t* Bt; bf16_t* O; float* DT; const float* rs; int lda, ldb, K, ldo; };
template <int EPI>
__device__ __forceinline__ void gemm_tile(const GemmArgs& g, int pm, int pn) {
    const int lane = threadIdx.x & 63, w = threadIdx.x >> 6, fr = lane & 15, fq = lane >> 4;
    const int row = pm * 128 + w * 16 + fr, col0 = pn * 256;
    f32x4 acc[16];
#pragma unroll
    for (int i = 0; i < 16; ++i) acc[i] = (f32x4){0.f, 0.f, 0.f, 0.f};
    const bf16_t* ap = g.A + (size_t)row * g.lda + fq * 8; const bf16_t* bp = g.Bt + (size_t)(col0 + fr) * g.ldb + fq * 8;
    for (int k = 0; k < g.K; k += 32) {
        const bf16x8 a = *(const bf16x8*)(ap + k);
#pragma unroll
        for (int nt = 0; nt < 16; ++nt) { const bf16x8 b = *(const bf16x8*)(bp + (size_t)nt * 16 * g.ldb + k); acc[nt] = __builtin_amdgcn_mfma_f32_16x16x32_bf16(b, a, acc[nt], 0, 0, 0); }
    }
    if (EPI == EPI_BF16 || EPI == EPI_COMPOSE) {
        const float s = EPI == EPI_COMPOSE ? g.rs[row] : 1.f;
#pragma unroll
        for (int nt = 0; nt < 16; ++nt) { u32x2 o; o.x = pk2(acc[nt][0] * s, acc[nt][1] * s); o.y = pk2(acc[nt][2] * s, acc[nt][3] * s); *(u32x2*)(g.O + (size_t)row * g.ldo + col0 + 16 * nt + 4 * fq) = o; }
    } else {
        bf16_t* prow = g.O + (size_t)row * PLD;
        if (pn < 12) { const int cb = pn < 4 ? PC_Z + 256 * pn : PC_XBC + 256 * (pn - 4);
#pragma unroll
            for (int nt = 0; nt < 16; ++nt) { u32x2 o; o.x = pk2(acc[nt][0], acc[nt][1]); o.y = pk2(acc[nt][2], acc[nt][3]); *(u32x2*)(prow + cb + 16 * nt + 4 * fq) = o; }
        } else if (pn < 28) { const int kt = pn - 12;
#pragma unroll
            for (int c4 = 0; c4 < 4; ++c4) { const f32x4 gv = acc[2 * c4], bg = acc[2 * c4 + 1], cg = acc[8 + 2 * c4], hv = acc[9 + 2 * c4]; const int ch = 64 * kt + 16 * c4 + 4 * fq;
                u32x2 o; o.x = pk2(bg[0] * siluf(gv[0]), bg[1] * siluf(gv[1])); o.y = pk2(bg[2] * siluf(gv[2]), bg[3] * siluf(gv[3])); *(u32x2*)(prow + PC_GT + ch) = o;
                u32x2 m; m.x = pk2(cg[0] * hv[0], cg[1] * hv[1]); m.y = pk2(cg[2] * hv[2], cg[3] * hv[3]); *(u32x2*)(prow + PC_CH + ch) = m; }
        } else {
#pragma unroll
            for (int nt = 0; nt < 2; ++nt) *(f32x4*)(g.DT + (size_t)row * 32 + 16 * nt + 4 * fq) = acc[nt];
        }
    }
}
template <int EPI>
__device__ __forceinline__ void gemm_simple_phase(const GemmArgs& g, int M, int N) {
    const int nM = M / 128, nN = N / 256;
    for (int t = blockIdx.x; t < nM * nN; t += gridDim.x) gemm_tile<EPI>(g, t / nN, t % nN);
}

struct OutArgs { const bf16_t* A; const bf16_t* Bt; const float* ssq; float* X; bf16_t* U; const float* mod; const float* modn; const float* lng; const float* lnb; int lda, pad; };
template <bool EVEN>
__device__ __forceinline__ void outproj_simple_phase(const OutArgs& g, unsigned char* lds) {
    float (*red)[2][4][16] = (float (*)[2][4][16])lds;
    const int lane = threadIdx.x & 63, half = threadIdx.x >> 8, w = (threadIdx.x >> 6) & 3, fr = lane & 15, fq = lane >> 4;
    for (int vb = blockIdx.x; vb < NTOK / 32; vb += gridDim.x) {
        const int row = (2 * vb + half) * 16 + fr, col0 = w * 256;
        f32x4 acc[16];
#pragma unroll
        for (int i = 0; i < 16; ++i) acc[i] = (f32x4){0.f, 0.f, 0.f, 0.f};
        float rr = 1.f;
        if (EVEN) { float s = 0.f;
#pragma unroll
            for (int h = 0; h < 16; ++h) s += g.ssq[(size_t)row * 16 + h];
            rr = 1.0f / sqrtf(s * (1.0f / 1024.0f) + RMS_EPS); }
        const bf16_t* ap = g.A + (size_t)row * g.lda + fq * 8; const bf16_t* bp = g.Bt + (size_t)(col0 + fr) * 2048 + fq * 8;
        for (int k = 0; k < 2048; k += 32) {
            if (EVEN && k == 1024) {
#pragma unroll
                for (int nt = 0; nt < 16; ++nt) acc[nt] = acc[nt] * rr; }
            const bf16x8 a = *(const bf16x8*)(ap + k);
#pragma unroll
            for (int nt = 0; nt < 16; ++nt) { const bf16x8 b = *(const bf16x8*)(bp + (size_t)nt * 16 * 2048 + k); acc[nt] = __builtin_amdgcn_mfma_f32_16x16x32_bf16(b, a, acc[nt], 0, 0, 0); }
        }
        const int bi = row_bi(row); const float* md = g.mod + (size_t)bi * 3072; float* xr = g.X + (size_t)row * D;
        float s = 0.f;
#pragma unroll
        for (int nt = 0; nt < 16; ++nt) { const int c = col0 + 16 * nt + 4 * fq; const f32x4 xv = *(const f32x4*)(xr + c), gt = *(const f32x4*)(md + 2048 + c);
            acc[nt] = ALPHA * xv + (1.f + gt) * acc[nt]; s += (acc[nt][0] + acc[nt][1]) + (acc[nt][2] + acc[nt][3]); }
        s += __shfl_xor(s, 16); s += __shfl_xor(s, 32);
        __syncthreads();
        if (fq == 0) red[half][0][w][fr] = s;
        __syncthreads();
        const float mean = (red[half][0][0][fr] + red[half][0][1][fr] + red[half][0][2][fr] + red[half][0][3][fr]) * (1.0f / 1024.0f);
        float qv = 0.f;
#pragma unroll
        for (int nt = 0; nt < 16; ++nt) { const f32x4 d = acc[nt] - mean; qv += (d[0] * d[0] + d[1] * d[1]) + (d[2] * d[2] + d[3] * d[3]); }
        qv += __shfl_xor(qv, 16); qv += __shfl_xor(qv, 32);
        if (fq == 0) red[half][1][w][fr] = qv;
        __syncthreads();
        const float rstd = 1.0f / sqrtf((red[half][1][0][fr] + red[half][1][1][fr] + red[half][1][2][fr] + red[half][1][3][fr]) * (1.0f / 1024.0f) + LN_EPS);
        const float* mn = g.modn ? g.modn + (size_t)bi * 3072 : nullptr;
#pragma unroll
        for (int nt = 0; nt < 16; ++nt) { const int c = col0 + 16 * nt + 4 * fq; const f32x4 gg = *(const f32x4*)(g.lng + c), bb = *(const f32x4*)(g.lnb + c);
            const f32x4 o = (acc[nt] - mean) * rstd * gg + bb; *(f32x4*)(xr + c) = o;
            if (mn) { const f32x4 sh = *(const f32x4*)(mn + c), scv = *(const f32x4*)(mn + 1024 + c); const f32x4 u = o * (1.f + scv) + sh; u32x2 ub; ub.x = pk2(u[0], u[1]); ub.y = pk2(u[2], u[3]); *(u32x2*)(g.U + (size_t)row * D + c) = ub; } }
    }
}

struct SsdArgs { bf16_t* P; const float* DT; bf16_t* stash; float* ssq; const float* state_in; float* state_out; const float* convw; const float* convb; const float* alog; const float* dtb; const float* dsk; const float* ng; int j, pad; };
__device__ __forceinline__ void ssd_simple_item(const SsdArgs& g, unsigned char* lds, int item) {
    float (*sx)[64] = (float (*)[64])lds; float (*sB)[128] = (float (*)[128])(lds + 8192); float (*sC)[128] = (float (*)[128])(lds + 8192 + 16384);
    float (*sy)[64] = (float (*)[64])(lds + 8192 + 32768); float* sdt = (float*)(lds + 8192 + 32768 + 8192);
    const int tid = threadIdx.x, h = item & 15, ba = item >> 4, grp = h >> 2;
    const bool ctx = ba < NCTX_B; const int L = ctx ? LCTX : LSMP, rbase = ctx ? ba * LCTX : NCTX + (ba - NCTX_B) * LSMP;
    const int p = tid >> 3, nq = tid & 7;
    for (int dir = 0; dir < 2; ++dir) {
        const float A = -__expf(g.alog[(g.j * 2 + dir) * 16 + h]), dbias = g.dtb[(g.j * 2 + dir) * 16 + h], dsk = g.dsk[g.j * 16 + h];
        float hs[16];
        if (ctx) {
#pragma unroll
            for (int n = 0; n < 16; ++n) hs[n] = 0.f;
        } else { const float* sp = g.state_in + ((((size_t)(ba - NCTX_B) * 2 + g.j) * 2 + dir) * 16 + h) * (64 * 128) + p * 128 + nq * 16;
#pragma unroll
            for (int n = 0; n < 16; ++n) hs[n] = sp[n]; }
        for (int blk = 0; blk < L / 32; ++blk) {
            const int t0 = dir == 0 ? blk * 32 : L - 32 - blk * 32;
            __syncthreads();
            for (int i = tid; i < 32 * 320; i += NTHR) { const int r = i / 320, cc = i % 320; const int t = t0 + r;
                const int xc = cc < 64 ? h * 64 + cc : (cc < 192 ? 1024 + grp * 128 + (cc - 64) : 1536 + grp * 128 + (cc - 192));
                float a = g.convb[g.j * 2048 + xc];
#pragma unroll
                for (int k = 0; k < 3; ++k) { const int tt = t - 1 + k; if (tt >= 0 && tt < L) a += g.convw[(g.j * 3 + k) * 2048 + xc] * bf2f(g.P[(size_t)(rbase + tt) * PLD + PC_XBC + xc]); }
                a = siluf(a);
                if (cc < 64) sx[r][cc] = a; else if (cc < 192) sB[r][cc - 64] = a; else sC[r][cc - 192] = a; }
            if (tid < 32) sdt[tid] = softplusf(g.DT[(size_t)(rbase + t0 + tid) * 32 + dir * 16 + h] + dbias);
            __syncthreads();
            for (int s = 0; s < 32; ++s) { const int r = dir == 0 ? s : 31 - s; const float dtv = sdt[r], da = __expf(dtv * A), xd = dtv * sx[r][p]; float y = 0.f;
#pragma unroll
                for (int n = 0; n < 16; ++n) { hs[n] = hs[n] * da + xd * sB[r][nq * 16 + n]; y += sC[r][nq * 16 + n] * hs[n]; }
                y += __shfl_xor(y, 1); y += __shfl_xor(y, 2); y += __shfl_xor(y, 4);
                if (nq == 0) sy[r][p] = y; }
            __syncthreads();
            if (dir == 0) { for (int i = tid; i < 32 * 64; i += NTHR) { const int r = i >> 6, pp = i & 63; g.stash[(size_t)(rbase + t0 + r) * D + h * 64 + pp] = (bf16_t)f2bf(sy[r][pp] + dsk * sx[r][pp]); } }
            else {
                for (int i = tid; i < 32 * 64; i += NTHR) { const int r = i >> 6, pp = i & 63; const size_t row = rbase + t0 + r;
                    const float y = sy[r][pp] + bf2f(g.stash[row * D + h * 64 + pp]); const float z = bf2f(g.P[row * PLD + PC_Z + h * 64 + pp]); sy[r][pp] = y * siluf(z); }
                __syncthreads();
                if (tid < 32) { float s2 = 0.f; for (int pp = 0; pp < 64; ++pp) s2 += sy[tid][pp] * sy[tid][pp]; g.ssq[(size_t)(rbase + t0 + tid) * 16 + h] = s2; }
                for (int i = tid; i < 32 * 64; i += NTHR) { const int r = i >> 6, pp = i & 63; g.P[(size_t)(rbase + t0 + r) * PLD + PC_Z + h * 64 + pp] = (bf16_t)f2bf(sy[r][pp] * g.ng[g.j * 1024 + h * 64 + pp]); }
            }
        }
        if (ctx) { float* sp = g.state_out + ((((size_t)ba * 2 + g.j) * 2 + dir) * 16 + h) * (64 * 128) + p * 128 + nq * 16;
#pragma unroll
            for (int n = 0; n < 16; ++n) sp[n] = hs[n]; }
    }
    __syncthreads();
}
__device__ __forceinline__ void mixb_rows(bf16_t* __restrict__ P, const float* __restrict__ cw, int j) {
    for (int vb = blockIdx.x; vb < NTOK / 2; vb += gridDim.x) {
        const int row = 2 * vb + (threadIdx.x >> 8), c0 = (threadIdx.x & 255) * 4; const bool ctx = row < NCTX; const int t = ctx ? (row & 255) : ((row - NCTX) & 1023), L = ctx ? LCTX : LSMP;
        float a[4] = {0.f, 0.f, 0.f, 0.f};
#pragma unroll
        for (int k = 0; k < 3; ++k) { const int tt = t - 1 + k; if (tt < 0 || tt >= L) continue; const u32x2 v = *(const u32x2*)(P + (size_t)(row - 1 + k) * PLD + PC_CH + c0); const f32x4 wv = *(const f32x4*)(cw + (size_t)(j * 3 + k) * 1024 + c0);
            a[0] += wv[0] * bflo(v.x); a[1] += wv[1] * bfhi(v.x); a[2] += wv[2] * bflo(v.y); a[3] += wv[3] * bfhi(v.y); }
        bf16_t* gp = P + (size_t)row * PLD + PC_GT + c0; const u32x2 gv = *(const u32x2*)gp; u32x2 o; o.x = pk2(bflo(gv.x) * a[0], bfhi(gv.x) * a[1]); o.y = pk2(bflo(gv.y) * a[2], bfhi(gv.y) * a[3]); *(u32x2*)gp = o;
    }
}
__device__ __forceinline__ void pool_rows(bf16_t* __restrict__ V) {
    for (int vb = blockIdx.x; vb < NTOK / 2; vb += gridDim.x) {
        const int row = 2 * vb + (threadIdx.x >> 8), c0 = (threadIdx.x & 255) * 8; const bool ctx = row < NCTX; const int t = ctx ? (row & 255) : ((row - NCTX) & 1023), L = ctx ? LCTX : LSMP;
        const int w = 2 << (c0 >> 9); int lo = t - w / 2, hi = t + w - w / 2; lo = lo < 0 ? 0 : lo; hi = hi > L ? L : hi;
        float s[8] = {0.f, 0.f, 0.f, 0.f, 0.f, 0.f, 0.f, 0.f};
        for (int tt = lo; tt < hi; ++tt) { const u32x4 v = *(const u32x4*)(V + (size_t)(row - t + tt) * VLD + c0);
            s[0] += bflo(v.x); s[1] += bfhi(v.x); s[2] += bflo(v.y); s[3] += bfhi(v.y); s[4] += bflo(v.z); s[5] += bfhi(v.z); s[6] += bflo(v.w); s[7] += bfhi(v.w); }
        const float inv = 1.0f / (float)(hi - lo); const u32x4 v = *(const u32x4*)(V + (size_t)row * VLD + c0); bf16_t* gp = V + (size_t)row * VLD + 2048 + c0; const u32x4 gv = *(const u32x4*)gp;
        const float vv[8] = {bflo(v.x), bfhi(v.x), bflo(v.y), bfhi(v.y), bflo(v.z), bfhi(v.z), bflo(v.w), bfhi(v.w)};
        const float gg[8] = {bflo(gv.x), bfhi(gv.x), bflo(gv.y), bfhi(gv.y), bflo(gv.z), bfhi(gv.z), bflo(gv.w), bfhi(gv.w)};
        float o[8];
#pragma unroll
        for (int e = 0; e < 8; ++e) o[e] = (s[e] * inv - vv[e]) * siluf(gg[e]);
        u32x4 ov; ov.x = pk2(o[0], o[1]); ov.y = pk2(o[2], o[3]); ov.z = pk2(o[4], o[5]); ov.w = pk2(o[6], o[7]); *(u32x4*)gp = ov;
    }
}

struct Params { const float* in[22]; float* out; unsigned char* ws; };
__global__ void __launch_bounds__(NTHR, 2) mega_fwd(Params prm) {
    extern __shared__ __attribute__((aligned(16))) unsigned char lds[];
    const int tid = threadIdx.x;
    Ptrs q;
    q.x_prompt = prm.in[0]; q.x_sample = prm.in[1]; q.state_ssd = prm.in[2]; q.c = prm.in[3]; q.c_ctx = prm.in[4]; q.w_mod = prm.in[5]; q.b_mod = prm.in[6]; q.ln_g = prm.in[7]; q.ln_b = prm.in[8];
    q.w_in_even = prm.in[9]; q.conv_a_w = prm.in[10]; q.conv_a_b = prm.in[11]; q.a_log = prm.in[12]; q.dt_bias = prm.in[13]; q.d_skip = prm.in[14]; q.norm_a_g = prm.in[15]; q.conv_b_w = prm.in[16];
    q.w_out_even = prm.in[17]; q.w_in_odd = prm.in[18]; q.w_pool = prm.in[19]; q.pool_scale = prm.in[20]; q.w_out_odd = prm.in[21];
    unsigned char* ws = prm.ws; q.X = prm.out; q.state_out = prm.out + (size_t)NTOK * D;
    q.MOD = (float*)(ws + WS_MOD); q.DT = (float*)(ws + WS_DT); q.SSQ = (float*)(ws + WS_SSQ);
    q.WIE = (bf16_t*)(ws + WS_WIE); q.WOE = (bf16_t*)(ws + WS_WOE); q.WIO = (bf16_t*)(ws + WS_WIO); q.WOO = (bf16_t*)(ws + WS_WOO);
    q.WPT = (bf16_t*)(ws + WS_WPT); q.WNAT = (bf16_t*)(ws + WS_WNAT); q.U = (bf16_t*)(ws + WS_U); q.P = (bf16_t*)(ws + WS_P);
    for (int u = tid; u < (LDS_BYTES - LDSCTL_OFF) / 4; u += NTHR) ((LAS unsigned*)((LAS unsigned char*)lds + LDSCTL_OFF))[u] = 0u;
    __syncthreads();
    XcdBarrier bar = xcd_barrier_post((unsigned*)(ws + WS_CTL) + CW_BAR, (volatile LAS unsigned*)((LAS unsigned char*)lds + MISC_OFF) + 8);
#define GRID_BAR() xcd_barrier(bar)

    phase0a(q, lds);
    GRID_BAR();
    xinit_rows(q);
    for (int t = blockIdx.x; t < 128; t += gridDim.x) {
        const int jk = t >> 4, j = jk >> 2, k = jk & 3, tt = t & 15;
        GemmArgs g{q.WPT + (size_t)jk * 512 * 512, q.WNAT + (size_t)j * 1024 * 2048 + 512 * k, q.WIO + (size_t)j * 4096 * 1024 + (size_t)512 * k * 1024, nullptr, q.pool_scale + j * 2048 + 512 * k, 512, 2048, 512, 1024};
        gemm_tile<EPI_COMPOSE>(g, tt >> 2, tt & 3);
    }
    GRID_BAR();
    for (int i = 0; i < 4; ++i) {
        const int j = i >> 1; const float* modi = q.MOD + (size_t)i * NBI * 3072; const float* modn = i < 3 ? q.MOD + (size_t)(i + 1) * NBI * 3072 : nullptr;
        if ((i & 1) == 0) {
            { GemmArgs g{q.U, q.WIE + (size_t)j * NEV * 1024, q.P, q.DT, nullptr, 1024, 1024, 1024, PLD}; gemm_simple_phase<EPI_INEVEN>(g, NTOK, NEV); }
            GRID_BAR();
            { SsdArgs s{q.P, q.DT, q.U, q.SSQ, q.state_ssd, q.state_out, q.conv_a_w, q.conv_a_b, q.a_log, q.dt_bias, q.d_skip, q.norm_a_g, j, 0};
              for (int it = blockIdx.x; it < 384; it += gridDim.x) { const int item = it < 128 ? 256 + it : it - 128; ssd_simple_item(s, lds, item); }
              mixb_rows(q.P, q.conv_b_w, j); }
            GRID_BAR();
            { OutArgs o{q.P, q.WOE + (size_t)j * 1024 * 2048, q.SSQ, q.X, q.U, modi, modn, q.ln_g + i * 1024, q.ln_b + i * 1024, PLD, 0}; outproj_simple_phase<true>(o, lds); }
        } else {
            { GemmArgs g{q.U, q.WIO + (size_t)j * 4096 * 1024, q.P, nullptr, nullptr, 1024, 1024, 1024, VLD}; gemm_simple_phase<EPI_BF16>(g, NTOK, 4096); }
            GRID_BAR();
            pool_rows(q.P);
            GRID_BAR();
            { OutArgs o{q.P + 2048, q.WOO + (size_t)j * 1024 * 2048, nullptr, q.X, q.U, modi, modn, q.ln_g + i * 1024, q.ln_b + i * 1024, VLD, 0}; outproj_simple_phase<false>(o, lds); }
        }
        if (i < 3) GRID_BAR();
    }
}

extern "C" void kernel_launch(void* const* d_in, const int* in_sizes, int n_in, void* d_out, int out_size, void* d_ws, size_t ws_size, hipStream_t stream) {
    static int grid = 0;
    if (grid == 0) {
        if (n_in != 22 || ws_size < WS_END) { fprintf(stderr, "kernel_launch: unexpected n_in %d / ws_size %zu\n", n_in, ws_size); grid = -1; return; }
        int dev = 0, cus = 0, per_cu = 0;
        if (hipGetDevice(&dev) != hipSuccess || hipDeviceGetAttribute(&cus, hipDeviceAttributeMultiprocessorCount, dev) != hipSuccess) { grid = -1; return; }
        if (hipFuncSetAttribute((const void*)mega_fwd, hipFuncAttributeMaxDynamicSharedMemorySize, LDS_BYTES) != hipSuccess) { fprintf(stderr, "kernel_launch: hipFuncSetAttribute failed\n"); grid = -1; return; }
        if (hipOccupancyMaxActiveBlocksPerMultiprocessor(&per_cu, (const void*)mega_fwd, NTHR, LDS_BYTES) != hipSuccess || per_cu < 1) fprintf(stderr, "kernel_launch: occupancy query says %d\n", per_cu);
        (void)hipGetLastError();
        grid = cus;
    }
    if (grid < 0) return;
    (void)hipMemsetAsync((char*)d_ws + WS_CTL, 0, CTL_ZERO_BYTES, stream);
    Params prm{};
    for (int i = 0; i < 22; ++i) prm.in[i] = (const float*)d_in[i];
    prm.out = (float*)d_out; prm.ws = (unsigned char*)d_ws;
    hipLaunchKernelGGL(mega_fwd, dim3(grid), dim3(NTHR), LDS_BYTES, stream, prm);
}
```
